# Optimizing an MI355X kernel written in HIP

```python
import math
import jax, jax.numpy as jnp
from jax import lax
import numpy as np

D_MODEL = 1024
BATCH = 8
SEQ = 4096
DEPTH = 1

HEAD_DIM = 64
N_HEADS_A = 8
N_KV_A = 2
GROUP_A = N_HEADS_A // N_KV_A
WINDOW_A = 128
N_HEADS_B = 8
DILATED_PATTERNS = ((128, 1), (512, 4), (2048, 16))
WIDTH_A = N_HEADS_A * HEAD_DIM
WIDTH_B = N_HEADS_B * HEAD_DIM
D_MIX = WIDTH_A + WIDTH_B
KV_WIDTH_A = N_KV_A * HEAD_DIM
D_IN_PROJ = WIDTH_A + 2 * KV_WIDTH_A + 3 * WIDTH_B
N_BIAS_HEADS = N_HEADS_A + N_HEADS_B
NUM_BUCKETS = 32
MAX_DISTANCE = 1024
D_FF = 4 * D_MODEL
PLE_DIM = 256
EPS = 1e-6
NEG = -1e30

kernel_name = "hybrid_wingqa_dilated_sandwich_layer"


def rmsnorm(x, g):
    xf = x.astype(jnp.float32)
    y = xf * lax.rsqrt(jnp.mean(xf * xf, axis=-1, keepdims=True) + EPS)
    return (y * g.astype(jnp.float32)).astype(x.dtype)


def t5_bucket(rel):
    half = NUM_BUCKETS // 2
    max_exact = half // 2
    sign = jnp.where(rel > 0, half, 0)
    n = jnp.abs(rel)
    nf = jnp.maximum(n, 1).astype(jnp.float32)
    large = max_exact + (jnp.log(nf / max_exact) / math.log(MAX_DISTANCE / max_exact)
                         * (half - max_exact)).astype(jnp.int32)
    large = jnp.minimum(large, half - 1)
    return sign + jnp.where(n < max_exact, n, large)


def band_rel(block):
    qi = jnp.arange(block)[:, None]
    ki = jnp.arange(3 * block)[None, :]
    return ki - block - qi


def banded_attention(q, k, v, bias, half_window, block, sink):
    b_, hk, g, L, dh = q.shape
    nb = -(-L // block)
    lp = nb * block
    q = jnp.pad(q, ((0, 0), (0, 0), (0, 0), (0, lp - L), (0, 0)))
    kv_pad = ((0, 0), (0, 0), (block, lp - L + block), (0, 0))
    kp = jnp.pad(k, kv_pad).reshape(b_, hk, nb + 2, block, dh)
    vp = jnp.pad(v, kv_pad).reshape(b_, hk, nb + 2, block, dh)
    kw = jnp.concatenate([kp[:, :, :-2], kp[:, :, 1:-1], kp[:, :, 2:]], axis=3)
    vw = jnp.concatenate([vp[:, :, :-2], vp[:, :, 1:-1], vp[:, :, 2:]], axis=3)
    qb = q.reshape(b_, hk, g, nb, block, dh)
    s = jnp.einsum('bhgnqd,bhnkd->bhgnqk', qb, kw).astype(jnp.float32) * (dh ** -0.5)
    s = s + bias[:, :, None]
    rel = band_rel(block)
    kpos = jnp.arange(nb)[:, None, None] * block + jnp.arange(3 * block)[None, None, :] - block
    valid = (jnp.abs(rel) <= half_window)[None] & (kpos >= 0) & (kpos < L)
    s = jnp.where(valid, s, NEG)
    m = jnp.max(s, axis=-1, keepdims=True)
    if sink is not None:
        sinkb = sink.astype(jnp.float32)[None, :, :, None, None, None]
        m = jnp.maximum(m, sinkb)
    e = jnp.exp(s - m)
    denom = jnp.sum(e, axis=-1, keepdims=True)
    if sink is not None:
        denom = denom + jnp.exp(sinkb - m)
    o = jnp.einsum('bhgnqk,bhnkd->bhgnqd', e, vw.astype(jnp.float32)) / denom
    lse = (jnp.log(denom) + m)[..., 0]
    o = o.reshape(b_, hk, g, lp, dh)[:, :, :, :L].astype(k.dtype)
    lse = lse.reshape(b_, hk, g, lp)[..., :L]
    return o, lse


def windowed_gqa_sink(qa, ka, va, bias_table, sink):
    b_, s_, _ = qa.shape
    q = qa.reshape(b_, s_, N_KV_A, GROUP_A, HEAD_DIM).transpose(0, 2, 3, 1, 4)
    k = ka.reshape(b_, s_, N_KV_A, HEAD_DIM).transpose(0, 2, 1, 3)
    v = va.reshape(b_, s_, N_KV_A, HEAD_DIM).transpose(0, 2, 1, 3)
    bias = bias_table[t5_bucket(band_rel(WINDOW_A))][..., :N_HEADS_A]
    bias = bias.transpose(2, 0, 1).reshape(N_KV_A, GROUP_A, WINDOW_A, 3 * WINDOW_A)
    o, _ = banded_attention(q, k, v, bias.astype(jnp.float32), WINDOW_A, WINDOW_A,
                            sink.reshape(N_KV_A, GROUP_A))
    return o.transpose(0, 3, 1, 2, 4).reshape(b_, s_, WIDTH_A)


def dilated_mixture(qb_, kb_, vb_, bias_table):
    b_, s_, _ = qb_.shape
    to_heads = lambda t: t.reshape(b_, s_, N_HEADS_B, HEAD_DIM).transpose(0, 2, 1, 3)
    q, k, v = to_heads(qb_), to_heads(kb_), to_heads(vb_)
    outs, lses = [], []
    for window, dil in DILATED_PATTERNS:
        half = window // (2 * dil)
        ls = s_ // dil
        sub = lambda t: t.reshape(b_, N_HEADS_B, ls, dil, HEAD_DIM).transpose(0, 1, 3, 2, 4) \
                         .reshape(b_, N_HEADS_B * dil, ls, HEAD_DIM)
        bias = bias_table[t5_bucket(band_rel(half) * dil)][..., N_HEADS_A:]
        bias = jnp.repeat(bias.transpose(2, 0, 1), dil, axis=0)[:, None]
        o, lse = banded_attention(sub(q)[:, :, None], sub(k), sub(v),
                                  bias.astype(jnp.float32), half, half, None)
        o = o.reshape(b_, N_HEADS_B, dil, ls, HEAD_DIM).transpose(0, 1, 3, 2, 4) \
             .reshape(b_, N_HEADS_B, s_, HEAD_DIM)
        lse = lse.reshape(b_, N_HEADS_B, dil, ls).transpose(0, 1, 3, 2).reshape(b_, N_HEADS_B, s_)
        outs.append(o)
        lses.append(lse)
    w = jax.nn.softmax(jnp.stack(lses, axis=0), axis=0)
    o = jnp.sum(w[..., None] * jnp.stack(outs, axis=0).astype(jnp.float32), axis=0).astype(q.dtype)
    return o.transpose(0, 2, 1, 3).reshape(b_, s_, WIDTH_B)


def setup_inputs(seed: int = 0) -> dict:
    key = jax.random.key(seed)
    ks = jax.random.split(key, 20)
    nrm = lambda k, shape, scale: (jax.random.normal(k, shape, jnp.float32) * scale)
    gain = lambda k, n: 1.0 + nrm(k, (DEPTH, n), 0.02)
    return {
        "x": nrm(ks[0], (BATCH, SEQ, D_MODEL), 1.0),
        "p": nrm(ks[1], (DEPTH, BATCH, SEQ, PLE_DIM), 1.0),
        "rel_bias_table": nrm(ks[2], (NUM_BUCKETS, N_BIAS_HEADS), 0.5),
        "g_pre_mix": gain(ks[3], D_MODEL),
        "w_in": nrm(ks[4], (DEPTH, D_MODEL, D_IN_PROJ), D_MODEL ** -0.5),
        "sink_a": nrm(ks[5], (DEPTH, N_HEADS_A), 0.5),
        "g_out_a": gain(ks[6], WIDTH_A),
        "g_out_b": gain(ks[7], WIDTH_B),
        "w_o": nrm(ks[8], (DEPTH, D_MIX, D_MODEL), D_MIX ** -0.5),
        "g_post_mix": gain(ks[9], D_MODEL),
        "g_pre_mlp": gain(ks[10], D_MODEL),
        "w_up": nrm(ks[11], (DEPTH, D_MODEL, D_FF), D_MODEL ** -0.5),
        "w_down": nrm(ks[12], (DEPTH, D_FF, D_MODEL), D_FF ** -0.5),
        "g_post_mlp": gain(ks[13], D_MODEL),
        "w_ple_proj": nrm(ks[14], (DEPTH, PLE_DIM, D_MODEL), PLE_DIM ** -0.5),
        "w_ple_gate": nrm(ks[15], (DEPTH, D_MODEL, D_MODEL), D_MODEL ** -0.5),
        "b_ple_gate": nrm(ks[16], (DEPTH, D_MODEL), 0.02),
        "g_post_ple": gain(ks[17], D_MODEL),
    }


def reference(x, p, rel_bias_table, g_pre_mix, w_in, sink_a, g_out_a, g_out_b, w_o,
              g_post_mix, g_pre_mlp, w_up, w_down, g_post_mlp, w_ple_proj, w_ple_gate,
              b_ple_gate, g_post_ple):
    h = x
    offs = np.cumsum([0, WIDTH_A, KV_WIDTH_A, KV_WIDTH_A, WIDTH_B, WIDTH_B, WIDTH_B])
    for i in range(DEPTH):
        u = rmsnorm(h, g_pre_mix[i])
        proj = jnp.einsum('bsd,de->bse', u, w_in[i])
        qa, ka, va, qb, kb, vb = [proj[..., offs[j]:offs[j + 1]] for j in range(6)]
        o_a = rmsnorm(windowed_gqa_sink(qa, ka, va, rel_bias_table, sink_a[i]), g_out_a[i])
        o_b = rmsnorm(dilated_mixture(qb, kb, vb, rel_bias_table), g_out_b[i])
        mix = jnp.einsum('bse,ed->bsd', jnp.concatenate([o_a, o_b], axis=-1), w_o[i])
        h = h + rmsnorm(mix, g_post_mix[i])
        v_ = rmsnorm(h, g_pre_mlp[i])
        a = jax.nn.relu(jnp.einsum('bsd,df->bsf', v_, w_up[i]))
        ff = jnp.einsum('bsf,fd->bsd', a * a, w_down[i])
        h = h + rmsnorm(ff, g_post_mlp[i])
        gate = jax.nn.sigmoid(jnp.einsum('bsd,de->bse', h, w_ple_gate[i]) + b_ple_gate[i])
        ple = jnp.einsum('bsk,kd->bsd', p[i], w_ple_proj[i])
        h = h + rmsnorm(gate * ple, g_post_ple[i])
    return h
```

```cpp
#include <hip/hip_runtime.h>
#include <cstdio>
#include <cstdint>
#include <cmath>

namespace {
constexpr int D_MODEL = 1024, BATCH = 8, SEQ = 4096, M = BATCH * SEQ;
constexpr int HEAD_DIM = 64, N_HEADS_A = 8, N_KV_A = 2, GROUP_A = 4, WINDOW_A = 128, N_HEADS_B = 8;
constexpr int WIDTH_A = 512, WIDTH_B = 512, D_MIX = 1024, KV_WIDTH_A = 128, D_IN_PROJ = 2304;
constexpr int N_BIAS_HEADS = 16, NUM_BUCKETS = 32, D_FF = 4096, PLE_DIM = 256;
constexpr float EPS = 1e-6f;
constexpr int OFF_QA = 0, OFF_KA = 512, OFF_VA = 640, OFF_QB = 768, OFF_KB = 1280, OFF_VB = 1792;

__device__ __forceinline__ int t5_bucket(int rel) {
    const int half = 16, max_exact = 8;
    int sign = rel > 0 ? half : 0;
    int n = rel < 0 ? -rel : rel;
    float nf = (float)(n > 1 ? n : 1);
    int large = max_exact + (int)(logf(nf / (float)max_exact) / logf(128.0f) * (float)(half - max_exact));
    if (large > half - 1) large = half - 1;
    return sign + (n < max_exact ? n : large);
}

__global__ void __launch_bounds__(256) rms_rows(const float* x, int ldx, const float* __restrict__ g, const float* res, int ldr, float* out, int ldo, int ncols) {
    __shared__ float red[4];
    const int row = blockIdx.x, tid = threadIdx.x;
    const float* xr = x + (size_t)row * ldx;
    float s = 0.f;
    for (int c = tid; c < ncols; c += 256) { float v = xr[c]; s += v * v; }
    for (int o = 32; o > 0; o >>= 1) s += __shfl_xor(s, o);
    if ((tid & 63) == 0) red[tid >> 6] = s;
    __syncthreads();
    const float tot = red[0] + red[1] + red[2] + red[3];
    const float r = 1.0f / sqrtf(tot / (float)ncols + EPS);
    for (int c = tid; c < ncols; c += 256) { float v = xr[c] * r * g[c]; if (res) v += res[(size_t)row * ldr + c]; out[(size_t)row * ldo + c] = v; }
}

template <int ACT>
__global__ void __launch_bounds__(256) gemm_f32(const float* __restrict__ A, int lda, const float* __restrict__ B, int ldb, float* __restrict__ C, int ldc, int K,
                                                const float* __restrict__ bias, const float* __restrict__ mul, int ldm) {
    __shared__ float sA[16][128 + 4];
    __shared__ float sB[16][128 + 4];
    const int tid = threadIdx.x, tx = tid & 15, ty = tid >> 4;
    const int m0 = blockIdx.y * 128, n0 = blockIdx.x * 128;
    float acc[8][8];
#pragma unroll
    for (int i = 0; i < 8; ++i)
#pragma unroll
        for (int j = 0; j < 8; ++j) acc[i][j] = 0.f;
    for (int k0 = 0; k0 < K; k0 += 16) {
#pragma unroll
        for (int i = 0; i < 2; ++i) { const int e = tid + i * 256; const int r = e >> 2, c4 = (e & 3) * 4; const float4 v = *(const float4*)(A + (size_t)(m0 + r) * lda + k0 + c4);
            sA[c4 + 0][r] = v.x; sA[c4 + 1][r] = v.y; sA[c4 + 2][r] = v.z; sA[c4 + 3][r] = v.w; }
#pragma unroll
        for (int i = 0; i < 2; ++i) { const int e = tid + i * 256; const int r = e >> 5, c4 = (e & 31) * 4; const float4 v = *(const float4*)(B + (size_t)(k0 + r) * ldb + n0 + c4);
            *(float4*)&sB[r][c4] = v; }
        __syncthreads();
#pragma unroll
        for (int k = 0; k < 16; ++k) {
            float a[8], b[8];
#pragma unroll
            for (int i = 0; i < 8; ++i) a[i] = sA[k][ty * 8 + i];
#pragma unroll
            for (int j = 0; j < 8; ++j) b[j] = sB[k][tx * 8 + j];
#pragma unroll
            for (int i = 0; i < 8; ++i)
#pragma unroll
                for (int j = 0; j < 8; ++j) acc[i][j] = fmaf(a[i], b[j], acc[i][j]);
        }
        __syncthreads();
    }
#pragma unroll
    for (int i = 0; i < 8; ++i) {
        const int r = m0 + ty * 8 + i;
#pragma unroll
        for (int j = 0; j < 8; ++j) {
            const int c = n0 + tx * 8 + j; float v = acc[i][j];
            if (ACT == 1) { v = v > 0.f ? v : 0.f; v = v * v; }
            if (ACT == 2) { v = 1.0f / (1.0f + expf(-(v + bias[c]))); v *= mul[(size_t)r * ldm + c]; }
            C[(size_t)r * ldc + c] = v;
        }
    }
}

__global__ void __launch_bounds__(64) attn_a_naive(const float* __restrict__ proj, const float* __restrict__ table, const float* __restrict__ sink, float* __restrict__ out) {
    const int gid = blockIdx.x * 64 + threadIdx.x;
    const int i = gid % SEQ, bh = gid / SEQ, h = bh % N_HEADS_A, b = bh / N_HEADS_A, hk = h / GROUP_A;
    const float* qp = proj + (size_t)(b * SEQ + i) * D_IN_PROJ + OFF_QA + h * HEAD_DIM;
    float q[64], o[64];
#pragma unroll
    for (int d = 0; d < 64; ++d) { q[d] = qp[d] * 0.125f; o[d] = 0.f; }
    const float sk = sink[h];
    float m = sk, l = 1.0f;
    int j0 = i - WINDOW_A; if (j0 < 0) j0 = 0; int j1 = i + WINDOW_A; if (j1 > SEQ - 1) j1 = SEQ - 1;
    for (int j = j0; j <= j1; ++j) {
        const float* kp = proj + (size_t)(b * SEQ + j) * D_IN_PROJ + OFF_KA + hk * HEAD_DIM;
        const float* vp = proj + (size_t)(b * SEQ + j) * D_IN_PROJ + OFF_VA + hk * HEAD_DIM;
        float s = 0.f;
#pragma unroll
        for (int d = 0; d < 64; ++d) s = fmaf(q[d], kp[d], s);
        s += table[t5_bucket(j - i) * N_BIAS_HEADS + h];
        const float mn = fmaxf(m, s), al = expf(m - mn), p = expf(s - mn);
        l = l * al + p;
#pragma unroll
        for (int d = 0; d < 64; ++d) o[d] = o[d] * al + p * vp[d];
        m = mn;
    }
    const float il = 1.0f / l;
    float* op = out + (size_t)(b * SEQ + i) * D_MIX + h * HEAD_DIM;
#pragma unroll
    for (int d = 0; d < 64; ++d) op[d] = o[d] * il;
}

__global__ void __launch_bounds__(64) attn_b_naive(const float* __restrict__ proj, const float* __restrict__ table, float* __restrict__ out) {
    const int gid = blockIdx.x * 64 + threadIdx.x;
    const int i = gid % SEQ, bh = gid / SEQ, h = bh % N_HEADS_B, b = bh / N_HEADS_B;
    const float* qp = proj + (size_t)(b * SEQ + i) * D_IN_PROJ + OFF_QB + h * HEAD_DIM;
    float q[64], o[64], ot[64];
#pragma unroll
    for (int d = 0; d < 64; ++d) { q[d] = qp[d] * 0.125f; ot[d] = 0.f; }
    float mt = -1e30f, lt = 0.f;
    const int dils[3] = {1, 4, 16};
#pragma unroll
    for (int p = 0; p < 3; ++p) {
        const int dil = dils[p];
#pragma unroll
        for (int d = 0; d < 64; ++d) o[d] = 0.f;
        float m = -1e30f, l = 0.f;
        for (int jj = -64; jj <= 64; ++jj) {
            const int j = i + jj * dil;
            if (j < 0 || j >= SEQ) continue;
            const float* kp = proj + (size_t)(b * SEQ + j) * D_IN_PROJ + OFF_KB + h * HEAD_DIM;
            const float* vp = proj + (size_t)(b * SEQ + j) * D_IN_PROJ + OFF_VB + h * HEAD_DIM;
            float s = 0.f;
#pragma unroll
            for (int d = 0; d < 64; ++d) s = fmaf(q[d], kp[d], s);
            s += table[t5_bucket(jj * dil) * N_BIAS_HEADS + N_HEADS_A + h];
            const float mn = fmaxf(m, s), al = expf(m - mn), pp = expf(s - mn);
            l = l * al + pp;
#pragma unroll
            for (int d = 0; d < 64; ++d) o[d] = o[d] * al + pp * vp[d];
            m = mn;
        }
        const float mn = fmaxf(mt, m), a0 = expf(mt - mn), a1 = expf(m - mn);
#pragma unroll
        for (int d = 0; d < 64; ++d) ot[d] = ot[d] * a0 + o[d] * a1;
        lt = lt * a0 + l * a1; mt = mn;
    }
    const float il = 1.0f / lt;
    float* op = out + (size_t)(b * SEQ + i) * D_MIX + WIDTH_A + h * HEAD_DIM;
#pragma unroll
    for (int d = 0; d < 64; ++d) op[d] = ot[d] * il;
}
}

extern "C" void kernel_launch(void* const* d_in, const int* in_sizes, int n_in, void* d_out, int out_size, void* d_ws, size_t ws_size, hipStream_t stream) {
    const float* x = (const float*)d_in[0]; const float* p = (const float*)d_in[1]; const float* table = (const float*)d_in[2];
    const float* g_pre_mix = (const float*)d_in[3]; const float* w_in = (const float*)d_in[4]; const float* sink_a = (const float*)d_in[5];
    const float* g_out_a = (const float*)d_in[6]; const float* g_out_b = (const float*)d_in[7]; const float* w_o = (const float*)d_in[8];
    const float* g_post_mix = (const float*)d_in[9]; const float* g_pre_mlp = (const float*)d_in[10]; const float* w_up = (const float*)d_in[11];
    const float* w_down = (const float*)d_in[12]; const float* g_post_mlp = (const float*)d_in[13]; const float* w_ple_proj = (const float*)d_in[14];
    const float* w_ple_gate = (const float*)d_in[15]; const float* b_ple_gate = (const float*)d_in[16]; const float* g_post_ple = (const float*)d_in[17];
    float* out = (float*)d_out;
    const size_t MiB = 1u << 20;
    if (ws_size < 480 * MiB) { fprintf(stderr, "kernel_launch: workspace too small (%zu)\n", ws_size); return; }
    float* U = (float*)((char*)d_ws + 0);
    float* PROJ = (float*)((char*)d_ws + 128 * MiB);
    float* ATT = (float*)((char*)d_ws + 416 * MiB);
    ATT = U;
    rms_rows<<<M, 256, 0, stream>>>(x, D_MODEL, g_pre_mix, nullptr, 0, U, D_MODEL, D_MODEL);
    gemm_f32<0><<<dim3(D_IN_PROJ / 128, M / 128), 256, 0, stream>>>(U, D_MODEL, w_in, D_IN_PROJ, PROJ, D_IN_PROJ, D_MODEL, nullptr, nullptr, 0);
    attn_a_naive<<<M * N_HEADS_A / 64, 64, 0, stream>>>(PROJ, table, sink_a, ATT);
    attn_b_naive<<<M * N_HEADS_B / 64, 64, 0, stream>>>(PROJ, table, ATT);
    rms_rows<<<M, 256, 0, stream>>>(ATT, D_MIX, g_out_a, nullptr, 0, ATT, D_MIX, WIDTH_A);
    rms_rows<<<M, 256, 0, stream>>>(ATT + WIDTH_A, D_MIX, g_out_b, nullptr, 0, ATT + WIDTH_A, D_MIX, WIDTH_B);
    float* MIX = PROJ;
    gemm_f32<0><<<dim3(D_MODEL / 128, M / 128), 256, 0, stream>>>(ATT, D_MIX, w_o, D_MODEL, MIX, D_MODEL, D_MIX, nullptr, nullptr, 0);
    rms_rows<<<M, 256, 0, stream>>>(MIX, D_MODEL, g_post_mix, x, D_MODEL, out, D_MODEL, D_MODEL);
    float* V = U;
    rms_rows<<<M, 256, 0, stream>>>(out, D_MODEL, g_pre_mlp, nullptr, 0, V, D_MODEL, D_MODEL);
    float* FF = PROJ;
    float* ACH = (float*)((char*)d_ws + 256 * MiB);
    constexpr int CH = 4096;
    for (int c = 0; c < M / CH; ++c) {
        gemm_f32<1><<<dim3(D_FF / 128, CH / 128), 256, 0, stream>>>(V + (size_t)c * CH * D_MODEL, D_MODEL, w_up, D_FF, ACH, D_FF, D_MODEL, nullptr, nullptr, 0);
        gemm_f32<0><<<dim3(D_MODEL / 128, CH / 128), 256, 0, stream>>>(ACH, D_FF, w_down, D_MODEL, FF + (size_t)c * CH * D_MODEL, D_MODEL, D_FF, nullptr, nullptr, 0);
    }
    rms_rows<<<M, 256, 0, stream>>>(FF, D_MODEL, g_post_mlp, out, D_MODEL, out, D_MODEL, D_MODEL);
    float* PLE = U;
    gemm_f32<0><<<dim3(D_MODEL / 128, M / 128), 256, 0, stream>>>(p, PLE_DIM, w_ple_proj, D_MODEL, PLE, D_MODEL, PLE_DIM, nullptr, nullptr, 0);
    float* T = PROJ;
    gemm_f32<2><<<dim3(D_MODEL / 128, M / 128), 256, 0, stream>>>(out, D_MODEL, w_ple_gate, D_MODEL, T, D_MODEL, D_MODEL, b_ple_gate, PLE, D_MODEL);
    rms_rows<<<M, 256, 0, stream>>>(T, D_MODEL, g_post_ple, out, D_MODEL, out, D_MODEL, D_MODEL);
}
```
